# Optimizing an MI355X kernel written in HIP

```python
import math
import jax, jax.numpy as jnp
from jax import lax
import numpy as np

D_MODEL = 1024
BATCH = 8
SEQ = 2048
DEPTH = 1

PLE_DIM = 256
D_MIX = D_MODEL
D_GMLP = D_MIX // 2
GMLP_GROUPS = 4
GMLP_GROUP_DIM = D_GMLP // GMLP_GROUPS
CHUNK = 128
D_ATTN = D_MIX - D_GMLP
HEAD_DIM = 64
N_Q_HEADS = D_ATTN // HEAD_DIM
N_KV_HEADS = 2
Q_PER_KV = N_Q_HEADS // N_KV_HEADS
WINDOW = 128
BLOCK = WINDOW
REL_BUCKETS = 32
REL_MAX_DIST = 128
D_FF = 4 * D_MODEL
D_IN = 2 * D_GMLP + D_ATTN + 2 * N_KV_HEADS * HEAD_DIM
EPS = 1e-6
NEG_INF = -1e30

kernel_name = "hybrid_gmlp_swa_sink_block"


def rmsnorm(x, g):
    xf = x.astype(jnp.float32)
    y = xf * lax.rsqrt(jnp.mean(xf * xf, axis=-1, keepdims=True) + EPS)
    return (y * g.astype(jnp.float32)).astype(x.dtype)


def t5_causal_bucket(n):
    max_exact = REL_BUCKETS // 2
    nf = jnp.maximum(n, 1).astype(jnp.float32)
    large = max_exact + (jnp.log(nf / max_exact) / math.log(REL_MAX_DIST / max_exact)
                         * (REL_BUCKETS - max_exact)).astype(jnp.int32)
    large = jnp.minimum(large, REL_BUCKETS - 1)
    return jnp.where(n < max_exact, n, large)


def band_bias_and_mask(rel_table):
    a = jnp.arange(BLOCK)[:, None]
    j = jnp.arange(2 * BLOCK)[None, :]
    n = BLOCK + a - j
    valid = (n >= 0) & (n < WINDOW)
    bucket = t5_causal_bucket(jnp.maximum(n, 0))
    bias = jnp.transpose(rel_table[bucket], (2, 0, 1))
    return bias, valid


def gmlp_chunk_mixer(u, v, v_gain, w_spatial, b_spatial):
    B, S, _ = u.shape
    nc = S // CHUNK
    vg = v.reshape(B, S, GMLP_GROUPS, GMLP_GROUP_DIM)
    vg = rmsnorm(vg, v_gain.reshape(GMLP_GROUPS, GMLP_GROUP_DIM))
    vc = vg.reshape(B, nc, CHUNK, GMLP_GROUPS, GMLP_GROUP_DIM)
    causal = jnp.tril(jnp.ones((CHUNK, CHUNK), dtype=bool))
    w = jnp.where(causal[None], w_spatial, 0).astype(vc.dtype)
    sv = jnp.einsum('gts,bnsgd->bntgd', w, vc) + jnp.transpose(b_spatial)[:, :, None].astype(vc.dtype)
    return u * sv.reshape(B, S, D_GMLP)


def swa_sink_attention(q, k, v, sinks, rel_table):
    B, S, _ = q.shape
    nb = S // BLOCK
    qb = q.reshape(B, nb, BLOCK, N_KV_HEADS, Q_PER_KV, HEAD_DIM)

    def band(t):
        t = t.reshape(B, S, N_KV_HEADS, HEAD_DIM)
        t = jnp.pad(t, ((0, 0), (BLOCK, 0), (0, 0), (0, 0)))
        t = t.reshape(B, nb + 1, BLOCK, N_KV_HEADS, HEAD_DIM)
        return jnp.concatenate([t[:, :-1], t[:, 1:]], axis=2)

    kb, vb = band(k), band(v)
    logits = jnp.einsum('bnqkgd,bnskd->bkgnqs', qb, kb).astype(jnp.float32) * (HEAD_DIM ** -0.5)
    bias, valid = band_bias_and_mask(rel_table)
    bias = bias.astype(jnp.float32).reshape(N_KV_HEADS, Q_PER_KV, 1, BLOCK, 2 * BLOCK)
    first = (jnp.arange(nb)[:, None, None] == 0) & (jnp.arange(2 * BLOCK)[None, None, :] < BLOCK)
    mask = valid[None] & ~first
    logits = jnp.where(mask, logits + bias, NEG_INF)
    sink = sinks.astype(jnp.float32).reshape(N_KV_HEADS, Q_PER_KV, 1, 1, 1)
    m = jnp.maximum(jnp.max(logits, axis=-1, keepdims=True), sink)
    e = jnp.exp(logits - m)
    denom = jnp.sum(e, axis=-1, keepdims=True) + jnp.exp(sink - m)
    probs = (e / denom).astype(v.dtype)
    out = jnp.einsum('bkgnqs,bnskd->bnqkgd', probs, vb)
    return out.reshape(B, S, D_ATTN)


def setup_inputs(seed: int = 0) -> dict:
    key = jax.random.key(seed)
    ks = jax.random.split(key, 16)
    f32 = jnp.float32
    nrm = lambda k, shape, s: jax.random.normal(k, shape, f32) * s
    return {
        "x": nrm(ks[0], (BATCH, SEQ, D_MODEL), 1.0),
        "p": nrm(ks[1], (DEPTH, BATCH, SEQ, PLE_DIM), 1.0),
        "norm1_gain": 1.0 + nrm(ks[2], (DEPTH, D_MODEL), 0.02),
        "w_in": nrm(ks[3], (DEPTH, D_MODEL, D_IN), D_MODEL ** -0.5),
        "gmlp_v_gain": 1.0 + nrm(ks[4], (DEPTH, D_GMLP), 0.02),
        "w_spatial": nrm(ks[5], (DEPTH, GMLP_GROUPS, CHUNK, CHUNK), CHUNK ** -0.5),
        "b_spatial": 1.0 + nrm(ks[6], (DEPTH, GMLP_GROUPS, CHUNK), 0.01),
        "attn_sinks": nrm(ks[7], (DEPTH, N_Q_HEADS), 0.5),
        "rel_bias_table": nrm(ks[8], (REL_BUCKETS, N_Q_HEADS), 0.5),
        "w_out": nrm(ks[9], (DEPTH, D_MIX, D_MODEL), D_MIX ** -0.5),
        "norm2_gain": 1.0 + nrm(ks[10], (DEPTH, D_MODEL), 0.02),
        "w_ff1": nrm(ks[11], (DEPTH, D_MODEL, D_FF), D_MODEL ** -0.5),
        "w_ff2": nrm(ks[12], (DEPTH, D_FF, D_MODEL), D_FF ** -0.5),
        "w_ple_proj": nrm(ks[13], (DEPTH, PLE_DIM, D_MODEL), PLE_DIM ** -0.5),
        "w_ple_gate": nrm(ks[14], (DEPTH, D_MODEL, D_MODEL), D_MODEL ** -0.5),
        "final_gain": 1.0 + nrm(ks[15], (D_MODEL,), 0.02),
    }


def reference(x, p, norm1_gain, w_in, gmlp_v_gain, w_spatial, b_spatial, attn_sinks,
              rel_bias_table, w_out, norm2_gain, w_ff1, w_ff2, w_ple_proj, w_ple_gate,
              final_gain):
    h = x
    for i in range(DEPTH):
        hn = rmsnorm(h, norm1_gain[i])
        z = hn @ w_in[i]
        zg = jax.nn.gelu(z[..., :2 * D_GMLP])
        u, vg = zg[..., :D_GMLP], zg[..., D_GMLP:]
        o = 2 * D_GMLP
        q = z[..., o:o + D_ATTN]
        kv_w = N_KV_HEADS * HEAD_DIM
        k = z[..., o + D_ATTN:o + D_ATTN + kv_w]
        v = z[..., o + D_ATTN + kv_w:]
        a_out = gmlp_chunk_mixer(u, vg, gmlp_v_gain[i], w_spatial[i], b_spatial[i])
        b_out = swa_sink_attention(q, k, v, attn_sinks[i], rel_bias_table)
        h = h + jnp.concatenate([a_out, b_out], axis=-1) @ w_out[i]
        hn = rmsnorm(h, norm2_gain[i])
        h = h + jnp.square(jax.nn.relu(hn @ w_ff1[i])) @ w_ff2[i]
        gate = jax.nn.sigmoid(h @ w_ple_gate[i])
        h = h + gate * (p[i] @ w_ple_proj[i])
    return rmsnorm(h, final_gain)
```

```cpp
#include <hip/hip_runtime.h>
#include <cstdio>
#include <cstdint>

typedef unsigned short bf16;
typedef short bf16x8 __attribute__((ext_vector_type(8)));
typedef float f32x4 __attribute__((ext_vector_type(4)));

constexpr int BATCH = 8, SEQ = 2048, D = 1024, M = BATCH * SEQ, PLE = 256, DG = 512, NG = 4, GD = 128, CHUNK = 128;
constexpr int DA = 512, HD = 64, NQH = 8, NKVH = 2, WIN = 128, FF = 4096, DIN = 1792, NBUCK = 32;
constexpr float EPS = 1e-6f;

constexpr size_t MiB = 1u << 20;
constexpr size_t WS_CTL = 0;
constexpr size_t WS_WIN = 2 * MiB, WS_WOUT = 6 * MiB, WS_W1 = 8 * MiB, WS_W2 = 16 * MiB, WS_WG = 24 * MiB, WS_WP = 26 * MiB;
constexpr size_t WS_WS = 26 * MiB + 512 * 1024;
constexpr size_t WS_BREL = 26 * MiB + 768 * 1024;
constexpr size_t WS_VRSTD = 29 * MiB;
constexpr size_t WS_XN = 32 * MiB, WS_PB = 64 * MiB, WS_PP = 72 * MiB, WS_HB = 104 * MiB, WS_Z = 104 * MiB, WS_MIX = 160 * MiB, WS_END = 232 * MiB;

__device__ __forceinline__ float bf2f(bf16 v) { return __uint_as_float(((unsigned)v) << 16); }
__device__ __forceinline__ bf16 f2bf(float f) { unsigned u = __float_as_uint(f); return (bf16)((u + 0x7fffu + ((u >> 16) & 1u)) >> 16); }
__device__ __forceinline__ float gelu_tanh(float x) { const float u = 1.5957691216f * (x + 0.044715f * x * x * x); return x / (1.0f + __expf(-u)); }
__device__ __forceinline__ float wave_sum(float v) {
#pragma unroll
    for (int o = 1; o < 64; o <<= 1) v += __shfl_xor(v, o);
    return v;
}

__global__ void nk_transpose_w(const float* __restrict__ W, int K, int N, bf16* __restrict__ WT) {
    const size_t i = (size_t)blockIdx.x * blockDim.x + threadIdx.x; if (i >= (size_t)K * N) return;
    const int n = (int)(i / K), k = (int)(i % K);
    WT[i] = f2bf(W[(size_t)k * N + n]);
}
__global__ void nk_prep_misc(const float* __restrict__ wsp, const float* __restrict__ rel, bf16* __restrict__ wst, float* __restrict__ brel) {
    const int i = blockIdx.x * blockDim.x + threadIdx.x;
    if (i < NG * CHUNK * CHUNK) { const int t = (i / CHUNK) % CHUNK, s = i % CHUNK; wst[i] = (s <= t) ? f2bf(wsp[i]) : (bf16)0; }
    if (i < NQH * WIN) { const int h = i / WIN, n = i % WIN; int b;
        if (n < 16) b = n; else { b = 16 + (int)(logf((float)n / 16.0f) / logf(8.0f) * 16.0f); if (b > 31) b = 31; }
        brel[i] = rel[b * NQH + h]; }
}
__global__ void nk_cvt_bf16(const float* __restrict__ in, bf16* __restrict__ out, size_t n) {
    const size_t i = (size_t)blockIdx.x * blockDim.x + threadIdx.x; if (i < n) out[i] = f2bf(in[i]);
}
__global__ void nk_rmsnorm_bf16(const float* __restrict__ x, const float* __restrict__ g, bf16* __restrict__ out) {
    const int row = blockIdx.x * (blockDim.x >> 6) + (threadIdx.x >> 6), lane = threadIdx.x & 63; if (row >= M) return;
    const float* xr = x + (size_t)row * D; float v[16]; float s = 0.f;
#pragma unroll
    for (int j = 0; j < 16; ++j) { v[j] = xr[lane + 64 * j]; s += v[j] * v[j]; }
    const float rstd = rsqrtf(wave_sum(s) * (1.0f / D) + EPS);
#pragma unroll
    for (int j = 0; j < 16; ++j) out[(size_t)row * D + lane + 64 * j] = f2bf(v[j] * rstd * g[lane + 64 * j]);
}
__global__ void nk_rmsnorm_f32_inplace(float* __restrict__ x, const float* __restrict__ g) {
    const int row = blockIdx.x * (blockDim.x >> 6) + (threadIdx.x >> 6), lane = threadIdx.x & 63; if (row >= M) return;
    float* xr = x + (size_t)row * D; float v[16]; float s = 0.f;
#pragma unroll
    for (int j = 0; j < 16; ++j) { v[j] = xr[lane + 64 * j]; s += v[j] * v[j]; }
    const float rstd = rsqrtf(wave_sum(s) * (1.0f / D) + EPS);
#pragma unroll
    for (int j = 0; j < 16; ++j) xr[lane + 64 * j] = v[j] * rstd * g[lane + 64 * j];
}
__global__ void nk_vrstd(const bf16* __restrict__ Z, float* __restrict__ vr) {
    const int i = blockIdx.x * (blockDim.x >> 6) + (threadIdx.x >> 6), lane = threadIdx.x & 63; if (i >= M * NG) return;
    const int row = i / NG, g = i % NG; const bf16* p = Z + (size_t)row * DIN + DG + g * GD;
    const float a = bf2f(p[lane]), b = bf2f(p[lane + 64]);
    const float s = wave_sum(a * a + b * b);
    if (lane == 0) vr[i] = rsqrtf(s * (1.0f / GD) + EPS);
}
__global__ void nk_gmlp(const bf16* __restrict__ Z, const float* __restrict__ vr, const float* __restrict__ vgain, const bf16* __restrict__ wst, const float* __restrict__ bsp, bf16* __restrict__ MIX) {
    const size_t i = (size_t)blockIdx.x * blockDim.x + threadIdx.x; if (i >= (size_t)M * DG) return;
    const int m = (int)(i / DG), c = (int)(i % DG), g = c / GD, t = m % CHUNK, base = m - t;
    const bf16* w = wst + ((size_t)g * CHUNK + t) * CHUNK; const float gn = vgain[c];
    float acc = 0.f;
    for (int s = 0; s <= t; ++s) { const float v = bf2f(Z[(size_t)(base + s) * DIN + DG + c]) * vr[(size_t)(base + s) * NG + g] * gn; acc += bf2f(w[s]) * bf2f(f2bf(v)); }
    const float u = bf2f(Z[(size_t)m * DIN + c]);
    MIX[(size_t)m * D + c] = f2bf(u * (acc + bsp[g * CHUNK + t]));
}
__global__ __launch_bounds__(64) void nk_attn(const bf16* __restrict__ Z, const float* __restrict__ brel, const float* __restrict__ sinks, bf16* __restrict__ MIX) {
    const int i = blockIdx.x * blockDim.x + threadIdx.x; if (i >= M * NQH) return;
    const int h = i % NQH, m = i / NQH, pos = m % SEQ, kvh = h / 4;
    float q[HD], o[HD];
    const bf16* qp = Z + (size_t)m * DIN + 2 * DG + h * HD;
#pragma unroll
    for (int d = 0; d < HD; ++d) { q[d] = bf2f(qp[d]); o[d] = 0.f; }
    float mr = sinks[h], l = 1.0f;
    const int blk0 = (pos / WIN) * WIN; int lo = pos - (WIN - 1); if (lo < blk0 - WIN) lo = blk0 - WIN; if (lo < 0) lo = 0;
    for (int kk = lo; kk <= pos; ++kk) {
        const bf16* kp = Z + (size_t)(m - pos + kk) * DIN + 2 * DG + DA + kvh * HD; const bf16* vp = kp + NKVH * HD;
        float s = 0.f;
#pragma unroll
        for (int d = 0; d < HD; ++d) s += q[d] * bf2f(kp[d]);
        s = s * 0.125f + brel[h * WIN + (pos - kk)];
        if (s > mr) { const float sc = __expf(mr - s); l *= sc;
#pragma unroll
            for (int d = 0; d < HD; ++d) o[d] *= sc;
            mr = s; }
        const float p = __expf(s - mr); l += p;
#pragma unroll
        for (int d = 0; d < HD; ++d) o[d] += p * bf2f(vp[d]);
    }
    const float il = 1.0f / l; bf16* op = MIX + (size_t)m * D + DG + h * HD;
#pragma unroll
    for (int d = 0; d < HD; ++d) op[d] = f2bf(o[d] * il);
}
enum { MODE_Z = 0, MODE_PP = 1, MODE_H1 = 2, MODE_FF1 = 3, MODE_H2 = 4, MODE_GATE = 5 };
template <int MODE> __global__ __launch_bounds__(256) void nk_gemm(const bf16* __restrict__ A, const bf16* __restrict__ Bt, int N, int K, bf16* __restrict__ ob, float* of, const float* __restrict__ xin, const bf16* __restrict__ pp) {
    const int wave = threadIdx.x >> 6, lane = threadIdx.x & 63, r = lane & 15, q = lane >> 4;
    const int m0 = blockIdx.y * 64 + (wave >> 1) * 32, n0 = blockIdx.x * 64 + (wave & 1) * 32;
    f32x4 acc[2][2];
#pragma unroll
    for (int i = 0; i < 2; ++i)
#pragma unroll
        for (int j = 0; j < 2; ++j) acc[i][j] = (f32x4){0.f, 0.f, 0.f, 0.f};
    for (int k0 = 0; k0 < K; k0 += 32) {
        bf16x8 a[2], b[2];
#pragma unroll
        for (int i = 0; i < 2; ++i) a[i] = *(const bf16x8*)(A + (size_t)(m0 + 16 * i + r) * K + k0 + 8 * q);
#pragma unroll
        for (int j = 0; j < 2; ++j) b[j] = *(const bf16x8*)(Bt + (size_t)(n0 + 16 * j + r) * K + k0 + 8 * q);
#pragma unroll
        for (int i = 0; i < 2; ++i)
#pragma unroll
            for (int j = 0; j < 2; ++j) acc[i][j] = __builtin_amdgcn_mfma_f32_16x16x32_bf16(a[i], b[j], acc[i][j], 0, 0, 0);
    }
#pragma unroll
    for (int i = 0; i < 2; ++i)
#pragma unroll
        for (int j = 0; j < 2; ++j)
#pragma unroll
            for (int t = 0; t < 4; ++t) {
                const int row = m0 + 16 * i + 4 * q + t, col = n0 + 16 * j + r; const float v = acc[i][j][t]; const size_t o = (size_t)row * N + col;
                if (MODE == MODE_Z) ob[o] = f2bf(col < 2 * DG ? gelu_tanh(v) : v);
                else if (MODE == MODE_PP) ob[o] = f2bf(v);
                else if (MODE == MODE_H1) of[o] = xin[o] + v;
                else if (MODE == MODE_FF1) { const float rl = v > 0.f ? v : 0.f; ob[o] = f2bf(rl * rl); }
                else if (MODE == MODE_H2) of[o] = of[o] + v;
                else if (MODE == MODE_GATE) of[o] = of[o] + bf2f(pp[o]) / (1.0f + __expf(-v));
            }
}

extern "C" void kernel_launch(void* const* d_in, const int* in_sizes, int n_in, void* d_out, int out_size, void* d_ws, size_t ws_size, hipStream_t stream) {
    if (n_in != 16 || out_size != M * D || ws_size < WS_END) { fprintf(stderr, "kernel_launch: unexpected shapes (n_in %d out %d ws %zu)\n", n_in, out_size, ws_size); return; }
    const float* x = (const float*)d_in[0]; const float* p = (const float*)d_in[1]; const float* g1 = (const float*)d_in[2]; const float* w_in = (const float*)d_in[3];
    const float* vgain = (const float*)d_in[4]; const float* wsp = (const float*)d_in[5]; const float* bsp = (const float*)d_in[6]; const float* sinks = (const float*)d_in[7];
    const float* rel = (const float*)d_in[8]; const float* w_out = (const float*)d_in[9]; const float* g2 = (const float*)d_in[10]; const float* w1 = (const float*)d_in[11];
    const float* w2 = (const float*)d_in[12]; const float* wp = (const float*)d_in[13]; const float* wg = (const float*)d_in[14]; const float* gf = (const float*)d_in[15];
    unsigned char* ws = (unsigned char*)d_ws; float* out = (float*)d_out;
    bf16 *WIN_T = (bf16*)(ws + WS_WIN), *WOUT_T = (bf16*)(ws + WS_WOUT), *W1_T = (bf16*)(ws + WS_W1), *W2_T = (bf16*)(ws + WS_W2), *WG_T = (bf16*)(ws + WS_WG), *WP_T = (bf16*)(ws + WS_WP);
    bf16 *WS_T = (bf16*)(ws + WS_WS), *XN = (bf16*)(ws + WS_XN), *PB = (bf16*)(ws + WS_PB), *PP = (bf16*)(ws + WS_PP), *HB = (bf16*)(ws + WS_HB), *Z = (bf16*)(ws + WS_Z), *MIX = (bf16*)(ws + WS_MIX);
    float *BREL = (float*)(ws + WS_BREL), *VR = (float*)(ws + WS_VRSTD);
    auto tr = [&](const float* W, int K, int N, bf16* WT) { const size_t n = (size_t)K * N; nk_transpose_w<<<(unsigned)((n + 255) / 256), 256, 0, stream>>>(W, K, N, WT); };
    tr(w_in, D, DIN, WIN_T); tr(w_out, D, D, WOUT_T); tr(w1, D, FF, W1_T); tr(w2, FF, D, W2_T); tr(wg, D, D, WG_T); tr(wp, PLE, D, WP_T);
    nk_prep_misc<<<(NG * CHUNK * CHUNK + 255) / 256, 256, 0, stream>>>(wsp, rel, WS_T, BREL);
    nk_rmsnorm_bf16<<<M / 4, 256, 0, stream>>>(x, g1, XN);
    nk_cvt_bf16<<<(M * PLE + 255) / 256, 256, 0, stream>>>(p, PB, (size_t)M * PLE);
    nk_gemm<MODE_Z><<<dim3(DIN / 64, M / 64), 256, 0, stream>>>(XN, WIN_T, DIN, D, Z, nullptr, nullptr, nullptr);
    nk_gemm<MODE_PP><<<dim3(D / 64, M / 64), 256, 0, stream>>>(PB, WP_T, D, PLE, PP, nullptr, nullptr, nullptr);
    nk_vrstd<<<M * NG / 4, 256, 0, stream>>>(Z, VR);
    nk_gmlp<<<(unsigned)(((size_t)M * DG + 255) / 256), 256, 0, stream>>>(Z, VR, vgain, WS_T, bsp, MIX);
    nk_attn<<<M * NQH / 64, 64, 0, stream>>>(Z, BREL, sinks, MIX);
    nk_gemm<MODE_H1><<<dim3(D / 64, M / 64), 256, 0, stream>>>(MIX, WOUT_T, D, D, nullptr, out, x, nullptr);
    nk_rmsnorm_bf16<<<M / 4, 256, 0, stream>>>(out, g2, XN);
    nk_gemm<MODE_FF1><<<dim3(FF / 64, M / 64), 256, 0, stream>>>(XN, W1_T, FF, D, HB, nullptr, nullptr, nullptr);
    nk_gemm<MODE_H2><<<dim3(D / 64, M / 64), 256, 0, stream>>>(HB, W2_T, D, FF, nullptr, out, nullptr, nullptr);
    nk_cvt_bf16<<<(M * D + 255) / 256, 256, 0, stream>>>(out, XN, (size_t)M * D);
    nk_gemm<MODE_GATE><<<dim3(D / 64, M / 64), 256, 0, stream>>>(XN, WG_T, D, D, nullptr, out, nullptr, PP);
    nk_rmsnorm_f32_inplace<<<M / 4, 256, 0, stream>>>(out, gf);
}
```
